# Optimizing an MI355X kernel written in HIP

```python
import math
import jax, jax.numpy as jnp
from jax import lax
import numpy as np

D_MODEL = 1024
BATCH = 16
SEQ = 2048
DEPTH = 1

N_HEADS = 16
N_KV_HEADS = 4
HEAD_DIM = 64
ATTN_WIDTH = N_HEADS * HEAD_DIM
KV_WIDTH = N_KV_HEADS * HEAD_DIM
WINDOW = 128
BLOCK = 128
REL_BUCKETS = 32
REL_MAX_DIST = 128
NEG_INF = -1e30
HYENA_WIDTH = 1024
HYENA_ORDER = 2
SHORT_CONV = 3
FILTER_EMB = 33
FILTER_HIDDEN = 64
DECAY_FAST = 0.3
DECAY_SLOW = 1.5
DECAY_TARGET = 1e-2
N_BRANCHES = 2
SPLIT_SIZES = (ATTN_WIDTH, KV_WIDTH, KV_WIDTH, ATTN_WIDTH,
               (HYENA_ORDER + 1) * HYENA_WIDTH, HYENA_WIDTH, N_BRANCHES * D_MODEL)
IN_COLS = ATTN_WIDTH + 2 * KV_WIDTH + ATTN_WIDTH + (HYENA_ORDER + 1) * HYENA_WIDTH + HYENA_WIDTH + N_BRANCHES * D_MODEL
DEEPNORM_ALPHA = (2 * DEPTH) ** 0.25
DEEPNORM_BETA = (8 * DEPTH) ** -0.25
LN_EPS = 1e-5

kernel_name = "hybrid_swa_hyena_deepnorm_encoder"


def _t5_bucket(rel):
    half = REL_BUCKETS // 2
    max_exact = half // 2
    ret = (rel > 0).astype(np.int32) * half
    n = np.abs(rel)
    n_safe = np.maximum(n, 1).astype(np.float32)
    large = max_exact + (np.log(n_safe / max_exact) / math.log(REL_MAX_DIST / max_exact)
                         * (half - max_exact)).astype(np.int32)
    large = np.minimum(large, half - 1)
    return (ret + np.where(n < max_exact, n, large)).astype(np.int32)


def _layer_norm(x, g, b):
    xf = x.astype(jnp.float32)
    mu = xf.mean(-1, keepdims=True)
    var = jnp.square(xf - mu).mean(-1, keepdims=True)
    y = (xf - mu) * lax.rsqrt(var + LN_EPS) * g.astype(jnp.float32) + b.astype(jnp.float32)
    return y.astype(x.dtype)


def _windowed_gqa(q, k, v, rel_bias, sink):
    b, s = q.shape[0], q.shape[1]
    nb = s // BLOCK
    g = N_HEADS // N_KV_HEADS
    scale = HEAD_DIM ** -0.5
    q = q.reshape(b, s, N_KV_HEADS, g, HEAD_DIM)
    pad = ((0, 0), (BLOCK, BLOCK), (0, 0), (0, 0))
    kp = jnp.pad(k, pad)
    vp = jnp.pad(v, pad)
    a = np.arange(BLOCK)[:, None]
    c = np.arange(3 * BLOCK)[None, :]
    rel = c - BLOCK - a
    band = jnp.asarray(np.abs(rel) <= WINDOW)
    bias = rel_bias.astype(jnp.float32)[_t5_bucket(rel)]
    bias = bias.transpose(2, 0, 1).reshape(N_KV_HEADS, g, BLOCK, 3 * BLOCK)
    sink_l = sink.astype(jnp.float32).reshape(1, N_KV_HEADS, g, 1, 1)
    offs = jnp.arange(3 * BLOCK)

    def attend_block(n):
        start = n * BLOCK
        qb = lax.dynamic_slice_in_dim(q, start, BLOCK, axis=1)
        kb = lax.dynamic_slice_in_dim(kp, start, 3 * BLOCK, axis=1)
        vb = lax.dynamic_slice_in_dim(vp, start, 3 * BLOCK, axis=1)
        key_pos = start - BLOCK + offs
        valid = band & ((key_pos >= 0) & (key_pos < s))[None, :]
        sc = jnp.einsum('bqkgd,bckd->bkgqc', qb, kb,
                        preferred_element_type=jnp.float32) * scale + bias
        sc = jnp.where(valid, sc, NEG_INF)
        m = jnp.maximum(sc.max(-1, keepdims=True), sink_l)
        e = jnp.exp(sc - m)
        p = e / (e.sum(-1, keepdims=True) + jnp.exp(sink_l - m))
        return jnp.einsum('bkgqc,bckd->bqkgd', p.astype(vb.dtype), vb)

    out = lax.map(attend_block, jnp.arange(nb))
    return out.transpose(1, 0, 2, 3, 4, 5).reshape(b, s, ATTN_WIDTH)


def _short_conv(u, w, bias):
    s = u.shape[1]
    half = SHORT_CONV // 2
    up = jnp.pad(u, ((0, 0), (half, half), (0, 0)))
    y = bias
    for j in range(SHORT_CONV):
        y = y + up[:, j:j + s] * w[j]
    return y


def _hyena_filters(seq_len, w1, b1, w2, b2, w3, b3, w4, freq):
    f32 = jnp.float32
    bands = (FILTER_EMB - 1) // 2
    t = jnp.linspace(0.0, 1.0, seq_len, dtype=f32)[:, None]
    w = 2.0 * math.pi * jnp.arange(seq_len, dtype=f32)[:, None] / seq_len
    fb = jnp.linspace(1e-4, bands - 1, bands, dtype=f32)[None, :]
    z = jnp.concatenate([t, jnp.cos(fb * w), -jnp.sin(fb * w)], axis=-1)
    fr = freq.astype(f32)
    h = jnp.sin(fr * (z @ w1.astype(f32) + b1.astype(f32)))
    h = jnp.sin(fr * (h @ w2.astype(f32) + b2.astype(f32)))
    h = jnp.sin(fr * (h @ w3.astype(f32) + b3.astype(f32)))
    h = h @ w4.astype(f32)
    max_decay = math.log(DECAY_TARGET) / DECAY_FAST
    min_decay = math.log(DECAY_TARGET) / DECAY_SLOW
    deltas = jnp.linspace(min_decay, max_decay, HYENA_WIDTH, dtype=f32)
    decay = jnp.exp(-t * jnp.abs(deltas))
    h = h.reshape(seq_len, 2, HYENA_WIDTH) * decay[:, None, :]
    return h[:, 0], h[:, 1]


def _bidir_long_conv(u, h_fwd, h_bwd):
    L = u.shape[1]
    k = jnp.concatenate([h_fwd, jnp.zeros((1, h_fwd.shape[1]), h_fwd.dtype), h_bwd[:0:-1]], axis=0)
    K = jnp.fft.rfft(k, axis=0)
    U = jnp.fft.rfft(u.astype(jnp.float32), n=2 * L, axis=1)
    y = jnp.fft.irfft(U * K[None], n=2 * L, axis=1)[:, :L]
    return y.astype(u.dtype)


def _hybrid_layer(x, w_in, rel_bias, attn_sink, conv_w, conv_b,
                  filt_w1, filt_b1, filt_w2, filt_b2, filt_w3, filt_b3, filt_w4, filt_freq,
                  hyena_skip, w_branch_attn, w_branch_hyena, w_out, ln_g, ln_b):
    b, s, _ = x.shape
    u = x @ w_in
    idx = np.cumsum(SPLIT_SIZES)[:-1].tolist()
    q, k, v, a_gate, hy, h_gate, br_gate = jnp.split(u, idx, axis=-1)
    y_a = _windowed_gqa(q.reshape(b, s, N_HEADS, HEAD_DIM),
                        k.reshape(b, s, N_KV_HEADS, HEAD_DIM),
                        v.reshape(b, s, N_KV_HEADS, HEAD_DIM), rel_bias, attn_sink)
    y_a = y_a * jax.nn.silu(a_gate)
    hc = _short_conv(hy, conv_w, conv_b)
    x0, x1, hv = jnp.split(hc, HYENA_ORDER + 1, axis=-1)
    z = hv * x1
    h_f, h_b = _hyena_filters(s, filt_w1, filt_b1, filt_w2, filt_b2, filt_w3, filt_b3, filt_w4, filt_freq)
    z = _bidir_long_conv(z, h_f, h_b) + z * hyena_skip
    y_h = z * x0 * jax.nn.silu(h_gate)
    g_a, g_h = jnp.split(jax.nn.sigmoid(br_gate), N_BRANCHES, axis=-1)
    merged = g_a * (y_a @ w_branch_attn) + g_h * (y_h @ w_branch_hyena)
    out = merged @ w_out
    return _layer_norm(DEEPNORM_ALPHA * x + out, ln_g, ln_b)


def setup_inputs(seed: int = 0) -> dict:
    key = jax.random.key(seed)
    ks = jax.random.split(key, 24)
    f32 = jnp.float32
    nrm = lambda k, shape, sc: jax.random.normal(k, shape, f32) * sc
    L_ = DEPTH
    C3 = (HYENA_ORDER + 1) * HYENA_WIDTH
    return {
        "x": nrm(ks[0], (BATCH, SEQ, D_MODEL), 1.0),
        "w_in": nrm(ks[1], (L_, D_MODEL, IN_COLS), D_MODEL ** -0.5),
        "rel_bias": nrm(ks[2], (REL_BUCKETS, N_HEADS), 0.5),
        "attn_sink": nrm(ks[3], (L_, N_HEADS), 0.5),
        "conv_w": nrm(ks[4], (L_, SHORT_CONV, C3), SHORT_CONV ** -0.5),
        "conv_b": nrm(ks[5], (L_, C3), 0.01),
        "filt_w1": nrm(ks[6], (L_, FILTER_EMB, FILTER_HIDDEN), FILTER_EMB ** -0.5),
        "filt_b1": nrm(ks[7], (L_, FILTER_HIDDEN), 0.1),
        "filt_w2": nrm(ks[8], (L_, FILTER_HIDDEN, FILTER_HIDDEN), FILTER_HIDDEN ** -0.5),
        "filt_b2": nrm(ks[9], (L_, FILTER_HIDDEN), 0.1),
        "filt_w3": nrm(ks[10], (L_, FILTER_HIDDEN, FILTER_HIDDEN), FILTER_HIDDEN ** -0.5),
        "filt_b3": nrm(ks[11], (L_, FILTER_HIDDEN), 0.1),
        "filt_w4": nrm(ks[12], (L_, FILTER_HIDDEN, 2 * HYENA_WIDTH), 0.05 * FILTER_HIDDEN ** -0.5),
        "filt_freq": 1.0 + nrm(ks[13], (L_, FILTER_HIDDEN), 0.05),
        "hyena_skip": nrm(ks[14], (L_, HYENA_WIDTH), 1.0),
        "w_branch_attn": nrm(ks[15], (L_, ATTN_WIDTH, D_MODEL), DEEPNORM_BETA * ATTN_WIDTH ** -0.5),
        "w_branch_hyena": nrm(ks[16], (L_, HYENA_WIDTH, D_MODEL), DEEPNORM_BETA * HYENA_WIDTH ** -0.5),
        "w_out": nrm(ks[17], (L_, D_MODEL, D_MODEL), DEEPNORM_BETA * D_MODEL ** -0.5),
        "ln_g": 1.0 + nrm(ks[18], (L_, D_MODEL), 0.01),
        "ln_b": nrm(ks[19], (L_, D_MODEL), 0.01),
    }


def reference(x, w_in, rel_bias, attn_sink, conv_w, conv_b, filt_w1, filt_b1, filt_w2, filt_b2,
              filt_w3, filt_b3, filt_w4, filt_freq, hyena_skip, w_branch_attn, w_branch_hyena,
              w_out, ln_g, ln_b):
    h = x
    for l in range(DEPTH):
        h = _hybrid_layer(h, w_in[l], rel_bias, attn_sink[l], conv_w[l], conv_b[l],
                          filt_w1[l], filt_b1[l], filt_w2[l], filt_b2[l], filt_w3[l], filt_b3[l],
                          filt_w4[l], filt_freq[l], hyena_skip[l], w_branch_attn[l],
                          w_branch_hyena[l], w_out[l], ln_g[l], ln_b[l])
    return h
```

```cpp
#include <hip/hip_runtime.h>
#include <cstdint>
#include <cstdio>

typedef unsigned short bf16_t;

constexpr int BATCH = 16, SEQ = 2048, DM = 1024, MTOK = BATCH * SEQ;
constexpr int INC = 8704;
constexpr int NH = 16, NKV = 4, HD = 64;
constexpr int C_Q = 0, C_K = 1024, C_V = 1280, C_AG = 1536, C_HY = 2560, C_HG = 5632, C_BR = 6656;
constexpr int HW = 1024;
constexpr float LN_EPS = 1e-5f;
constexpr float DN_ALPHA = 1.189207115002721f;

constexpr size_t MiB = 1u << 20;
constexpr size_t WS_H3 = 1 * MiB;
constexpr size_t WS_KF = 26 * MiB;
constexpr size_t WS_XB = 64 * MiB;
constexpr size_t WS_HYT = 128 * MiB;
constexpr size_t WS_Q = 192 * MiB;
constexpr size_t WS_K = 256 * MiB;
constexpr size_t WS_V = 272 * MiB;
constexpr size_t WS_AG = 288 * MiB;
constexpr size_t WS_YH = 352 * MiB;
constexpr size_t WS_END = 416 * MiB;

__device__ __forceinline__ float bf2f(bf16_t h) { return __uint_as_float(((unsigned)h) << 16); }
__device__ __forceinline__ bf16_t f2bf(float f) { unsigned u = __float_as_uint(f); return (bf16_t)((u + 0x7fffu + ((u >> 16) & 1u)) >> 16); }
__device__ __forceinline__ float siluf(float v) { return v / (1.f + __expf(-v)); }
__device__ __forceinline__ float sigmf(float v) { return 1.f / (1.f + __expf(-v)); }

__global__ void k_cvt_x(const float* __restrict__ x, bf16_t* __restrict__ xb, size_t n4) {
    size_t i = (size_t)blockIdx.x * blockDim.x + threadIdx.x;
    const size_t stride = (size_t)gridDim.x * blockDim.x;
    for (; i < n4; i += stride) {
        const float4 v = ((const float4*)x)[i];
        ushort4 o; o.x = f2bf(v.x); o.y = f2bf(v.y); o.z = f2bf(v.z); o.w = f2bf(v.w);
        ((ushort4*)xb)[i] = o;
    }
}

__global__ void k_filter_mlp(const float* __restrict__ w1, const float* __restrict__ b1, const float* __restrict__ w2, const float* __restrict__ b2,
                             const float* __restrict__ w3, const float* __restrict__ b3, const float* __restrict__ freq, float* __restrict__ H3) {
    __shared__ float zf[64];
    __shared__ float h[64];
    const int t = blockIdx.x, j = threadIdx.x;
    const float tt = (float)t / 2047.0f;
    const float w = 6.283185307179586f * (float)t / 2048.0f;
    if (j < 33) {
        float v;
        if (j == 0) v = tt;
        else {
            const int i = (j - 1) & 15;
            const float fb = 1e-4f + (float)i * ((15.0f - 1e-4f) / 15.0f);
            const float a = fb * w;
            v = (j <= 16) ? cosf(a) : -sinf(a);
        }
        zf[j] = v;
    }
    __syncthreads();
    const float fr = freq[j];
    float a = b1[j];
    for (int k = 0; k < 33; ++k) a += zf[k] * w1[k * 64 + j];
    float hv = sinf(fr * a);
    h[j] = hv; __syncthreads();
    a = b2[j];
    for (int k = 0; k < 64; ++k) a += h[k] * w2[k * 64 + j];
    hv = sinf(fr * a);
    __syncthreads(); h[j] = hv; __syncthreads();
    a = b3[j];
    for (int k = 0; k < 64; ++k) a += h[k] * w3[k * 64 + j];
    hv = sinf(fr * a);
    H3[t * 64 + j] = hv;
}
__global__ void k_filter_k(const float* __restrict__ H3, const float* __restrict__ w4, bf16_t* __restrict__ KF) {
    const int i = blockIdx.x;
    const int c = blockIdx.y * 256 + threadIdx.x;
    const int d = i - 2048;
    float val = 0.f;
    if (d > -2048) {
        const int ad = d < 0 ? -d : d;
        const float* hrow = H3 + ad * 64;
        const float* wc = w4 + (d < 0 ? 1024 + c : c);
        float a = 0.f;
        for (int k = 0; k < 64; ++k) a += hrow[k] * wc[k * 2048];
        const float mind = -3.0701134573253944f, maxd = -15.350567286626972f;
        const float delta = mind + (float)c * ((maxd - mind) / 1023.0f);
        const float tt = (float)ad / 2047.0f;
        val = a * __expf(-tt * fabsf(delta));
    }
    KF[(size_t)c * 4096 + i] = f2bf(val);
}

__device__ __forceinline__ void gemm_core(const bf16_t* __restrict__ A, int lda, const float* __restrict__ W, int ldw, int K, float (&acc)[4][4],
                                          float (*sA)[68], float (*sB)[68]) {
    const int tid = threadIdx.x, tx = tid & 15, ty = tid >> 4;
    for (int k0 = 0; k0 < K; k0 += 16) {
        { const int r = tid >> 2, kk = (tid & 3) * 4; const ushort4 v = *(const ushort4*)(A + (size_t)r * lda + k0 + kk);
          sA[kk + 0][r] = bf2f(v.x); sA[kk + 1][r] = bf2f(v.y); sA[kk + 2][r] = bf2f(v.z); sA[kk + 3][r] = bf2f(v.w); }
        { const int kk = tid >> 4, n = (tid & 15) * 4; const float4 v = *(const float4*)(W + (size_t)(k0 + kk) * ldw + n);
          sB[kk][n] = v.x; sB[kk][n + 1] = v.y; sB[kk][n + 2] = v.z; sB[kk][n + 3] = v.w; }
        __syncthreads();
#pragma unroll
        for (int kk = 0; kk < 16; ++kk) {
            float a[4], b[4];
#pragma unroll
            for (int i = 0; i < 4; ++i) { a[i] = sA[kk][ty * 4 + i]; b[i] = sB[kk][tx * 4 + i]; }
#pragma unroll
            for (int i = 0; i < 4; ++i)
#pragma unroll
                for (int j = 0; j < 4; ++j) acc[i][j] += a[i] * b[j];
        }
        __syncthreads();
    }
}

__global__ void __launch_bounds__(256) k_gemm1a(const bf16_t* __restrict__ XB, const float* __restrict__ w_in, bf16_t* __restrict__ HYT) {
    __shared__ float sA[16][68], sB[16][68];
    const int m0 = blockIdx.y * 64, n0 = blockIdx.x * 64;
    float acc[4][4] = {};
    gemm_core(XB + (size_t)m0 * DM, DM, w_in + C_HY + n0, INC, DM, acc, sA, sB);
    const int tx = threadIdx.x & 15, ty = threadIdx.x >> 4;
#pragma unroll
    for (int i = 0; i < 4; ++i)
#pragma unroll
        for (int j = 0; j < 4; ++j) {
            const int m = m0 + ty * 4 + i, n = n0 + tx * 4 + j; float v = acc[i][j];
            if (n >= 3072) v = siluf(v);
            HYT[(size_t)n * MTOK + m] = f2bf(v);
        }
}
__global__ void __launch_bounds__(256) k_gemm1b(const bf16_t* __restrict__ XB, const float* __restrict__ w_in, bf16_t* __restrict__ Q, bf16_t* __restrict__ Kb, bf16_t* __restrict__ Vb,
                                                bf16_t* __restrict__ AG, bf16_t* __restrict__ BR) {
    __shared__ float sA[16][68], sB[16][68];
    const int m0 = blockIdx.y * 64, n0 = blockIdx.x * 64;
    const int wcol = n0 < 2560 ? n0 : C_BR + (n0 - 2560);
    float acc[4][4] = {};
    gemm_core(XB + (size_t)m0 * DM, DM, w_in + wcol, INC, DM, acc, sA, sB);
    const int tx = threadIdx.x & 15, ty = threadIdx.x >> 4;
#pragma unroll
    for (int i = 0; i < 4; ++i)
#pragma unroll
        for (int j = 0; j < 4; ++j) {
            const int m = m0 + ty * 4 + i, n = n0 + tx * 4 + j; const float v = acc[i][j];
            if (n < 1024) Q[(size_t)m * 1024 + n] = f2bf(v * 0.125f);
            else if (n < 1280) Kb[(size_t)m * 256 + (n - 1024)] = f2bf(v);
            else if (n < 1536) Vb[(size_t)m * 256 + (n - 1280)] = f2bf(v);
            else if (n < 2560) AG[(size_t)m * 1024 + (n - 1536)] = f2bf(siluf(v));
            else BR[(size_t)m * 2048 + (n - 2560)] = f2bf(sigmf(v));
        }
}
__global__ void __launch_bounds__(256) k_gemm3a(const bf16_t* __restrict__ YA, const bf16_t* __restrict__ YH, const float* __restrict__ Wba, const float* __restrict__ Wbh,
                                                const bf16_t* __restrict__ BR, bf16_t* __restrict__ MG) {
    __shared__ float sA[16][68], sB[16][68];
    const int m0 = blockIdx.y * 64, n0 = blockIdx.x * 64;
    float acca[4][4] = {}, acch[4][4] = {};
    gemm_core(YA + (size_t)m0 * DM, DM, Wba + n0, DM, DM, acca, sA, sB);
    gemm_core(YH + (size_t)m0 * DM, DM, Wbh + n0, DM, DM, acch, sA, sB);
    const int tx = threadIdx.x & 15, ty = threadIdx.x >> 4;
#pragma unroll
    for (int i = 0; i < 4; ++i)
#pragma unroll
        for (int j = 0; j < 4; ++j) {
            const int m = m0 + ty * 4 + i, n = n0 + tx * 4 + j;
            const float ga = bf2f(BR[(size_t)m * 2048 + n]), gh = bf2f(BR[(size_t)m * 2048 + 1024 + n]);
            MG[(size_t)m * 1024 + n] = f2bf(ga * acca[i][j] + gh * acch[i][j]);
        }
}
__global__ void __launch_bounds__(256) k_gemm3b(const bf16_t* __restrict__ MG, const float* __restrict__ Wout, const float* __restrict__ x, float* __restrict__ out) {
    __shared__ float sA[16][68], sB[16][68];
    const int m0 = blockIdx.y * 64, n0 = blockIdx.x * 64;
    float acc[4][4] = {};
    gemm_core(MG + (size_t)m0 * DM, DM, Wout + n0, DM, DM, acc, sA, sB);
    const int tx = threadIdx.x & 15, ty = threadIdx.x >> 4;
#pragma unroll
    for (int i = 0; i < 4; ++i)
#pragma unroll
        for (int j = 0; j < 4; ++j) {
            const int m = m0 + ty * 4 + i, n = n0 + tx * 4 + j;
            out[(size_t)m * 1024 + n] = DN_ALPHA * x[(size_t)m * 1024 + n] + acc[i][j];
        }
}
__global__ void __launch_bounds__(256) k_ln(float* __restrict__ out, const float* __restrict__ g, const float* __restrict__ bta) {
    const int row = blockIdx.x * 4 + (threadIdx.x >> 6), lane = threadIdx.x & 63;
    float4* p = (float4*)(out + (size_t)row * 1024) + lane;
    float4 v[4]; float s = 0.f;
#pragma unroll
    for (int j = 0; j < 4; ++j) { v[j] = p[64 * j]; s += (v[j].x + v[j].y) + (v[j].z + v[j].w); }
#pragma unroll
    for (int o = 1; o < 64; o <<= 1) s += __shfl_xor(s, o);
    const float mean = s * (1.f / 1024.f); float q = 0.f;
#pragma unroll
    for (int j = 0; j < 4; ++j) { v[j].x -= mean; v[j].y -= mean; v[j].z -= mean; v[j].w -= mean; q += (v[j].x * v[j].x + v[j].y * v[j].y) + (v[j].z * v[j].z + v[j].w * v[j].w); }
#pragma unroll
    for (int o = 1; o < 64; o <<= 1) q += __shfl_xor(q, o);
    const float rstd = rsqrtf(q * (1.f / 1024.f) + LN_EPS);
#pragma unroll
    for (int j = 0; j < 4; ++j) {
        const float4 gg = ((const float4*)g)[64 * j + lane], bb = ((const float4*)bta)[64 * j + lane];
        float4 o; o.x = v[j].x * rstd * gg.x + bb.x; o.y = v[j].y * rstd * gg.y + bb.y; o.z = v[j].z * rstd * gg.z + bb.z; o.w = v[j].w * rstd * gg.w + bb.w;
        p[64 * j] = o;
    }
}

__global__ void __launch_bounds__(256) k_hyena_naive(bf16_t* __restrict__ HYT, const bf16_t* __restrict__ KF, const float* __restrict__ conv_w, const float* __restrict__ conv_b,
                                                     const float* __restrict__ skip) {
    __shared__ float zs[2048];
    __shared__ float kf[4096];
    const int c = blockIdx.x, b = blockIdx.y, tid = threadIdx.x;
    const bf16_t* x0r = HYT + (size_t)c * MTOK + (size_t)b * SEQ;
    const bf16_t* x1r = HYT + (size_t)(1024 + c) * MTOK + (size_t)b * SEQ;
    const bf16_t* vr = HYT + (size_t)(2048 + c) * MTOK + (size_t)b * SEQ;
    const bf16_t* sgr = HYT + (size_t)(3072 + c) * MTOK + (size_t)b * SEQ;
    const float w00 = conv_w[c], w01 = conv_w[3072 + c], w02 = conv_w[6144 + c], cb0 = conv_b[c];
    const float w10 = conv_w[1024 + c], w11 = conv_w[3072 + 1024 + c], w12 = conv_w[6144 + 1024 + c], cb1 = conv_b[1024 + c];
    const float w20 = conv_w[2048 + c], w21 = conv_w[3072 + 2048 + c], w22 = conv_w[6144 + 2048 + c], cb2 = conv_b[2048 + c];
    float x0c[8], zz[8], sg[8];
#pragma unroll
    for (int j = 0; j < 8; ++j) {
        const int t = tid + 256 * j;
        const float a0 = t > 0 ? bf2f(x0r[t - 1]) : 0.f, a1 = bf2f(x0r[t]), a2 = t < SEQ - 1 ? bf2f(x0r[t + 1]) : 0.f;
        const float b0 = t > 0 ? bf2f(x1r[t - 1]) : 0.f, b1 = bf2f(x1r[t]), b2 = t < SEQ - 1 ? bf2f(x1r[t + 1]) : 0.f;
        const float c0 = t > 0 ? bf2f(vr[t - 1]) : 0.f, c1 = bf2f(vr[t]), c2 = t < SEQ - 1 ? bf2f(vr[t + 1]) : 0.f;
        x0c[j] = cb0 + w00 * a0 + w01 * a1 + w02 * a2;
        const float x1 = cb1 + w10 * b0 + w11 * b1 + w12 * b2;
        const float hv = cb2 + w20 * c0 + w21 * c1 + w22 * c2;
        zz[j] = bf2f(f2bf(hv * x1));
        zs[t] = zz[j];
        sg[j] = bf2f(sgr[t]);
    }
    for (int i = tid; i < 4096; i += 256) kf[i] = bf2f(KF[(size_t)c * 4096 + i]);
    __syncthreads();
    float y[8] = {};
    for (int s = 0; s < SEQ; ++s) {
        const float z = zs[s];
#pragma unroll
        for (int j = 0; j < 8; ++j) y[j] += kf[tid + 256 * j - s + 2048] * z;
    }
    const float sk = skip[c];
    bf16_t* yo = HYT + (size_t)c * MTOK + (size_t)b * SEQ;
#pragma unroll
    for (int j = 0; j < 8; ++j) yo[tid + 256 * j] = f2bf((y[j] + zz[j] * sk) * x0c[j] * sg[j]);
}

__global__ void __launch_bounds__(256) k_transpose(const bf16_t* __restrict__ in, bf16_t* __restrict__ out, int R, int C) {
    __shared__ bf16_t tile[64][66];
    const int c0 = blockIdx.x * 64, r0 = blockIdx.y * 64, tx = threadIdx.x & 63, ty = threadIdx.x >> 6;
    for (int r = ty; r < 64; r += 4) tile[r][tx] = in[(size_t)(r0 + r) * C + c0 + tx];
    __syncthreads();
    for (int r = ty; r < 64; r += 4) out[(size_t)(c0 + r) * R + r0 + tx] = tile[tx][r];
}

__device__ __forceinline__ int t5_bucket(int rel) {
    const int n = rel < 0 ? -rel : rel; int v;
    if (n < 8) v = n; else if (n < 12) v = 8; else if (n < 16) v = 9; else if (n < 23) v = 10; else if (n < 32) v = 11; else if (n < 46) v = 12; else if (n < 64) v = 13; else if (n < 91) v = 14; else v = 15;
    return v + (rel > 0 ? 16 : 0);
}
__global__ void __launch_bounds__(128) k_attn_naive(bf16_t* __restrict__ Q, const bf16_t* __restrict__ Kb, const bf16_t* __restrict__ Vb, const bf16_t* __restrict__ AG,
                                                    const float* __restrict__ rel_bias, const float* __restrict__ sink) {
    __shared__ float bt[257];
    const int qb = blockIdx.x, h = blockIdx.y, b = blockIdx.z, tid = threadIdx.x;
    for (int i = tid; i < 257; i += 128) bt[i] = rel_bias[t5_bucket(i - 128) * NH + h];
    __syncthreads();
    const int q = qb * 128 + tid, kvh = h >> 2;
    const size_t tok = (size_t)b * SEQ + q;
    float qv[64], o[64];
    { const ushort4* qp = (const ushort4*)(Q + tok * 1024 + h * 64);
#pragma unroll
      for (int i = 0; i < 16; ++i) { const ushort4 v = qp[i]; qv[4 * i] = bf2f(v.x); qv[4 * i + 1] = bf2f(v.y); qv[4 * i + 2] = bf2f(v.z); qv[4 * i + 3] = bf2f(v.w); } }
#pragma unroll
    for (int i = 0; i < 64; ++i) o[i] = 0.f;
    float m = sink[h], l = 1.f;
    const int j0 = q - 128 < 0 ? 0 : q - 128, j1 = q + 128 > SEQ - 1 ? SEQ - 1 : q + 128;
    for (int j = j0; j <= j1; ++j) {
        const ushort4* kp = (const ushort4*)(Kb + ((size_t)b * SEQ + j) * 256 + kvh * 64);
        float s = 0.f;
#pragma unroll
        for (int i = 0; i < 16; ++i) { const ushort4 v = kp[i]; s += qv[4 * i] * bf2f(v.x) + qv[4 * i + 1] * bf2f(v.y) + qv[4 * i + 2] * bf2f(v.z) + qv[4 * i + 3] * bf2f(v.w); }
        s += bt[j - q + 128];
        const float mn = fmaxf(m, s), sc = __expf(m - mn), p = __expf(s - mn);
        l = l * sc + p; m = mn;
        const ushort4* vp = (const ushort4*)(Vb + ((size_t)b * SEQ + j) * 256 + kvh * 64);
#pragma unroll
        for (int i = 0; i < 16; ++i) { const ushort4 v = vp[i];
            o[4 * i] = o[4 * i] * sc + p * bf2f(v.x); o[4 * i + 1] = o[4 * i + 1] * sc + p * bf2f(v.y); o[4 * i + 2] = o[4 * i + 2] * sc + p * bf2f(v.z); o[4 * i + 3] = o[4 * i + 3] * sc + p * bf2f(v.w); }
    }
    const float rl = 1.f / l;
    const ushort4* gp = (const ushort4*)(AG + tok * 1024 + h * 64);
    ushort4* op = (ushort4*)(Q + tok * 1024 + h * 64);
#pragma unroll
    for (int i = 0; i < 16; ++i) { const ushort4 g = gp[i]; ushort4 w;
        w.x = f2bf(o[4 * i] * rl * bf2f(g.x)); w.y = f2bf(o[4 * i + 1] * rl * bf2f(g.y)); w.z = f2bf(o[4 * i + 2] * rl * bf2f(g.z)); w.w = f2bf(o[4 * i + 3] * rl * bf2f(g.w)); op[i] = w; }
}

extern "C" void kernel_launch(void* const* d_in, const int* in_sizes, int n_in, void* d_out, int out_size, void* d_ws, size_t ws_size, hipStream_t stream) {
    if (n_in != 20 || out_size != MTOK * DM || ws_size < WS_END) { fprintf(stderr, "kernel_launch: unexpected shapes (n_in %d out %d ws %zu)\n", n_in, out_size, ws_size); return; }
    const float* x = (const float*)d_in[0]; const float* w_in = (const float*)d_in[1]; const float* rel_bias = (const float*)d_in[2]; const float* sink = (const float*)d_in[3];
    const float* conv_w = (const float*)d_in[4]; const float* conv_b = (const float*)d_in[5];
    const float* fw1 = (const float*)d_in[6]; const float* fb1 = (const float*)d_in[7]; const float* fw2 = (const float*)d_in[8]; const float* fb2 = (const float*)d_in[9];
    const float* fw3 = (const float*)d_in[10]; const float* fb3 = (const float*)d_in[11]; const float* fw4 = (const float*)d_in[12]; const float* ffreq = (const float*)d_in[13];
    const float* skip = (const float*)d_in[14]; const float* wba = (const float*)d_in[15]; const float* wbh = (const float*)d_in[16]; const float* wout = (const float*)d_in[17];
    const float* ln_g = (const float*)d_in[18]; const float* ln_b = (const float*)d_in[19];
    unsigned char* ws = (unsigned char*)d_ws; float* out = (float*)d_out;
    float* H3 = (float*)(ws + WS_H3); bf16_t* KF = (bf16_t*)(ws + WS_KF); bf16_t* XB = (bf16_t*)(ws + WS_XB); bf16_t* HYT = (bf16_t*)(ws + WS_HYT);
    bf16_t* Q = (bf16_t*)(ws + WS_Q); bf16_t* Kb = (bf16_t*)(ws + WS_K); bf16_t* Vb = (bf16_t*)(ws + WS_V); bf16_t* AG = (bf16_t*)(ws + WS_AG); bf16_t* YH = (bf16_t*)(ws + WS_YH);
    bf16_t* MG = XB; bf16_t* BR = (bf16_t*)d_out;

    k_cvt_x<<<2048, 256, 0, stream>>>(x, XB, (size_t)MTOK * DM / 4);
    k_filter_mlp<<<2048, 64, 0, stream>>>(fw1, fb1, fw2, fb2, fw3, fb3, ffreq, H3);
    k_filter_k<<<dim3(4096, 4), 256, 0, stream>>>(H3, fw4, KF);
    k_gemm1a<<<dim3(4096 / 64, MTOK / 64), 256, 0, stream>>>(XB, w_in, HYT);
    k_hyena_naive<<<dim3(1024, 16), 256, 0, stream>>>(HYT, KF, conv_w, conv_b, skip);
    k_transpose<<<dim3(MTOK / 64, 1024 / 64), 256, 0, stream>>>(HYT, YH, 1024, MTOK);
    k_gemm1b<<<dim3(4608 / 64, MTOK / 64), 256, 0, stream>>>(XB, w_in, Q, Kb, Vb, AG, BR);
    k_attn_naive<<<dim3(SEQ / 128, NH, BATCH), 128, 0, stream>>>(Q, Kb, Vb, AG, rel_bias, sink);
    k_gemm3a<<<dim3(1024 / 64, MTOK / 64), 256, 0, stream>>>(Q, YH, wba, wbh, BR, MG);
    k_gemm3b<<<dim3(1024 / 64, MTOK / 64), 256, 0, stream>>>(MG, wout, x, out);
    k_ln<<<MTOK / 4, 256, 0, stream>>>(out, ln_g, ln_b);
}
```
